# Optimizing an MI355X kernel written in HIP

```python
import jax, jax.numpy as jnp
from jax import lax
import numpy as np

D_MODEL = 1024
BATCH = 8
SEQ = 2048
DEPTH = 1
DEC_BATCH = 128
DEC_SEQ = 4
PAST_LEN = 8192
PAGE_SIZE = 128

POOL_WINDOWS = (2, 4, 8, 16)
N_POOL_GROUPS = len(POOL_WINDOWS)
POOL_GROUP = D_MODEL // 8
POOL_WIDTH = N_POOL_GROUPS * POOL_GROUP
POOL_BUF = max(POOL_WINDOWS) - 1
N_HEADS = 8
N_KV_HEADS = 2
HEAD_DIM = 64
GROUP = N_HEADS // N_KV_HEADS
Q_WIDTH = N_HEADS * HEAD_DIM
KV_WIDTH = N_KV_HEADS * HEAD_DIM
WINDOW = 128
ROPE_THETA = 10000.0
N_BRANCH = 2
IN_WIDTH = POOL_WIDTH + Q_WIDTH + 2 * KV_WIDTH + N_BRANCH * D_MODEL
D_FF = ((8 * D_MODEL // 3 + 127) // 128) * 128
ALPHA = (2.0 * DEPTH) ** 0.25
BETA = (8.0 * DEPTH) ** -0.25
LN_EPS = 1e-5
NEG_INF = -1e30

kernel_name = "hybrid_pool_swa_macaron_deepnorm_step"


def layer_norm(x, g, b):
    xf = x.astype(jnp.float32)
    mu = jnp.mean(xf, axis=-1, keepdims=True)
    var = jnp.mean(jnp.square(xf - mu), axis=-1, keepdims=True)
    y = (xf - mu) * lax.rsqrt(var + LN_EPS) * g.astype(jnp.float32) + b.astype(jnp.float32)
    return y.astype(x.dtype)


def swiglu(x, w1, w3, w2):
    return (jax.nn.silu(x @ w1) * (x @ w3)) @ w2


def ffn_half_step(x, w1, w3, w2, g, b):
    return layer_norm(ALPHA * x + 0.5 * swiglu(x, w1, w3, w2), g, b)


def rope(x, pos):
    half = HEAD_DIM // 2
    freqs = ROPE_THETA ** (-2.0 * jnp.arange(half, dtype=jnp.float32) / HEAD_DIM)
    ang = pos.astype(jnp.float32)[:, None] * freqs[None, :]
    cos = jnp.cos(ang)[:, None, :]
    sin = jnp.sin(ang)[:, None, :]
    xf = x.astype(jnp.float32)
    x1, x2 = xf[..., :half], xf[..., half:]
    return jnp.concatenate([x1 * cos - x2 * sin, x1 * sin + x2 * cos], axis=-1).astype(x.dtype)


def split_in(h, w_in):
    B, T, _ = h.shape
    z = h @ w_in
    o = 0
    u = z[..., o:o + POOL_WIDTH]; o += POOL_WIDTH
    q = z[..., o:o + Q_WIDTH].reshape(B, T, N_HEADS, HEAD_DIM); o += Q_WIDTH
    k = z[..., o:o + KV_WIDTH].reshape(B, T, N_KV_HEADS, HEAD_DIM); o += KV_WIDTH
    v = z[..., o:o + KV_WIDTH].reshape(B, T, N_KV_HEADS, HEAD_DIM); o += KV_WIDTH
    gates = z[..., o:].reshape(B, T, N_BRANCH, D_MODEL)
    return u, q, k, v, gates


def multiscale_pool(ctx, u, start_pos, w_grp, scale):
    B, T, P = u.shape
    C = ctx.shape[1]
    maxw = max(POOL_WINDOWS)
    full = jnp.concatenate([jnp.zeros((B, maxw, P), jnp.float32),
                            ctx.astype(jnp.float32), u.astype(jnp.float32)], axis=1)
    cs = jnp.cumsum(full, axis=1)
    lo = maxw + C
    cur = cs[:, lo:lo + T]
    pos = start_pos + jnp.arange(T, dtype=jnp.int32)
    uf = u.astype(jnp.float32)
    groups = []
    for g, w in enumerate(POOL_WINDOWS):
        sl = slice(g * POOL_GROUP, (g + 1) * POOL_GROUP)
        win_sum = cur[..., sl] - cs[:, lo - w:lo - w + T, sl]
        cnt = jnp.minimum(pos + 1, w).astype(jnp.float32)[None, :, None]
        groups.append(win_sum / cnt - uf[..., sl])
    z = jnp.stack(groups, axis=2).astype(u.dtype)
    z = jnp.einsum('btgc,gcd->btgd', z, w_grp).reshape(B, T, P)
    return z * scale


def sink_attention(qb, kb, vb, mask, sinks):
    s = jnp.einsum('bnqkgd,bnjkd->bnkgqj', qb, kb,
                   preferred_element_type=jnp.float32) * (HEAD_DIM ** -0.5)
    s = jnp.where(mask[None, :, None, None], s, NEG_INF)
    sink = sinks.astype(jnp.float32)[None, None, :, :, None]
    m = jnp.maximum(jnp.max(s, axis=-1), sink)
    p = jnp.exp(s - m[..., None])
    denom = jnp.sum(p, axis=-1) + jnp.exp(sink - m)
    probs = (p / denom[..., None]).astype(vb.dtype)
    return jnp.einsum('bnkgqj,bnjkd->bnqkgd', probs, vb)


def merge_out(pool_z, attn_o, gates, w_pool_out, w_attn_out, w_out):
    g = jax.nn.sigmoid(gates.astype(jnp.float32)).astype(pool_z.dtype)
    m = g[..., 0, :] * (pool_z @ w_pool_out) + g[..., 1, :] * (attn_o @ w_attn_out)
    return m @ w_out


def mixer_prompt(h, w_in, w_grp, pool_scale, sinks, w_pool_out, w_attn_out, w_out):
    B, S, _ = h.shape
    u, q, k, v, gates = split_in(h, w_in)
    pos = jnp.arange(S, dtype=jnp.int32)
    q = rope(q, pos)
    k = rope(k, pos)
    pool_z = multiscale_pool(jnp.zeros((B, 0, POOL_WIDTH), u.dtype), u, 0, w_grp, pool_scale)
    nb = S // WINDOW
    qb = q.reshape(B, nb, WINDOW, N_KV_HEADS, GROUP, HEAD_DIM)
    kb = k.reshape(B, nb, WINDOW, N_KV_HEADS, HEAD_DIM)
    vb = v.reshape(B, nb, WINDOW, N_KV_HEADS, HEAD_DIM)
    kk = jnp.concatenate([jnp.concatenate([jnp.zeros_like(kb[:, :1]), kb[:, :-1]], axis=1), kb], axis=2)
    vv = jnp.concatenate([jnp.concatenate([jnp.zeros_like(vb[:, :1]), vb[:, :-1]], axis=1), vb], axis=2)
    blk = jnp.arange(nb, dtype=jnp.int32)[:, None] * WINDOW
    qpos = blk + jnp.arange(WINDOW, dtype=jnp.int32)[None, :]
    kpos = blk - WINDOW + jnp.arange(2 * WINDOW, dtype=jnp.int32)[None, :]
    diff = qpos[:, :, None] - kpos[:, None, :]
    mask = (diff >= 0) & (diff <= WINDOW) & (kpos[:, None, :] >= 0)
    attn = sink_attention(qb, kk, vv, mask, sinks.reshape(N_KV_HEADS, GROUP))
    attn_o = attn.reshape(B, S, Q_WIDTH)
    m = merge_out(pool_z, attn_o, gates, w_pool_out, w_attn_out, w_out)
    wb = min(WINDOW, S)
    return m, u[:, S - POOL_BUF:], k[:, S - wb:], v[:, S - wb:]


def mixer_sample(h, pool_ctx, k_ctx, v_ctx, w_in, w_grp, pool_scale, sinks,
                 w_pool_out, w_attn_out, w_out):
    Bd, T, _ = h.shape
    wb = k_ctx.shape[1]
    u, q, k, v, gates = split_in(h, w_in)
    pos = PAST_LEN + jnp.arange(T, dtype=jnp.int32)
    q = rope(q, pos)
    k = rope(k, pos)
    pool_z = multiscale_pool(pool_ctx, u, PAST_LEN, w_grp, pool_scale)
    k_all = jnp.concatenate([k_ctx, k], axis=1)
    v_all = jnp.concatenate([v_ctx, v], axis=1)
    kpos = PAST_LEN - wb + jnp.arange(wb + T, dtype=jnp.int32)
    diff = pos[:, None] - kpos[None, :]
    mask = ((diff >= 0) & (diff <= WINDOW) & (kpos[None, :] >= 0))[None]
    qb = q.reshape(Bd, 1, T, N_KV_HEADS, GROUP, HEAD_DIM)
    attn = sink_attention(qb, k_all[:, None], v_all[:, None], mask, sinks.reshape(N_KV_HEADS, GROUP))
    attn_o = attn.reshape(Bd, T, Q_WIDTH)
    m = merge_out(pool_z, attn_o, gates, w_pool_out, w_attn_out, w_out)
    u_all = jnp.concatenate([pool_ctx, u], axis=1)
    return m, u_all[:, u_all.shape[1] - POOL_BUF:], k_all[:, T:], v_all[:, T:]


def setup_inputs(seed: int = 0) -> dict:
    key = jax.random.key(seed)
    ks = jax.random.split(key, 32)
    f32 = jnp.float32
    wb = min(WINDOW, PAST_LEN)

    def nrm(k, shape, scale):
        return jax.random.normal(k, shape, f32) * scale

    L = DEPTH
    return {
        "x_prompt": nrm(ks[0], (BATCH, SEQ, D_MODEL), 1.0),
        "x_sample": nrm(ks[1], (DEC_BATCH, DEC_SEQ, D_MODEL), 1.0),
        "cache_pool_u": nrm(ks[2], (L, DEC_BATCH, POOL_BUF, POOL_WIDTH), 1.0),
        "cache_k_win": nrm(ks[3], (L, DEC_BATCH, wb, N_KV_HEADS, HEAD_DIM), 1.0),
        "cache_v_win": nrm(ks[4], (L, DEC_BATCH, wb, N_KV_HEADS, HEAD_DIM), 1.0),
        "w_in": nrm(ks[5], (L, D_MODEL, IN_WIDTH), D_MODEL ** -0.5),
        "pool_w_grp": nrm(ks[6], (L, N_POOL_GROUPS, POOL_GROUP, POOL_GROUP), POOL_GROUP ** -0.5),
        "pool_scale": 1.0 + nrm(ks[7], (L, POOL_WIDTH), 0.1),
        "attn_sinks": nrm(ks[8], (L, N_HEADS), 0.5),
        "w_pool_out": nrm(ks[9], (L, POOL_WIDTH, D_MODEL), POOL_WIDTH ** -0.5),
        "w_attn_out": nrm(ks[10], (L, Q_WIDTH, D_MODEL), Q_WIDTH ** -0.5),
        "w_out": nrm(ks[11], (L, D_MODEL, D_MODEL), BETA * D_MODEL ** -0.5),
        "ffn1_w1": nrm(ks[12], (L, D_MODEL, D_FF), D_MODEL ** -0.5),
        "ffn1_w3": nrm(ks[13], (L, D_MODEL, D_FF), D_MODEL ** -0.5),
        "ffn1_w2": nrm(ks[14], (L, D_FF, D_MODEL), BETA * D_FF ** -0.5),
        "ffn2_w1": nrm(ks[15], (L, D_MODEL, D_FF), D_MODEL ** -0.5),
        "ffn2_w3": nrm(ks[16], (L, D_MODEL, D_FF), D_MODEL ** -0.5),
        "ffn2_w2": nrm(ks[17], (L, D_FF, D_MODEL), BETA * D_FF ** -0.5),
        "ln1_g": 1.0 + nrm(ks[18], (L, D_MODEL), 0.02),
        "ln1_b": nrm(ks[19], (L, D_MODEL), 0.02),
        "ln2_g": 1.0 + nrm(ks[20], (L, D_MODEL), 0.02),
        "ln2_b": nrm(ks[21], (L, D_MODEL), 0.02),
        "ln3_g": 1.0 + nrm(ks[22], (L, D_MODEL), 0.02),
        "ln3_b": nrm(ks[23], (L, D_MODEL), 0.02),
    }


def reference(x_prompt, x_sample, cache_pool_u, cache_k_win, cache_v_win,
              w_in, pool_w_grp, pool_scale, attn_sinks, w_pool_out, w_attn_out, w_out,
              ffn1_w1, ffn1_w3, ffn1_w2, ffn2_w1, ffn2_w3, ffn2_w2,
              ln1_g, ln1_b, ln2_g, ln2_b, ln3_g, ln3_b):
    xp, xs = x_prompt, x_sample
    pu_l, pk_l, pv_l, su_l, sk_l, sv_l = [], [], [], [], [], []
    for l in range(DEPTH):
        hp = ffn_half_step(xp, ffn1_w1[l], ffn1_w3[l], ffn1_w2[l], ln1_g[l], ln1_b[l])
        hs = ffn_half_step(xs, ffn1_w1[l], ffn1_w3[l], ffn1_w2[l], ln1_g[l], ln1_b[l])
        mp, pu, pk, pv = mixer_prompt(hp, w_in[l], pool_w_grp[l], pool_scale[l], attn_sinks[l],
                                      w_pool_out[l], w_attn_out[l], w_out[l])
        ms, su, sk, sv = mixer_sample(hs, cache_pool_u[l], cache_k_win[l], cache_v_win[l],
                                      w_in[l], pool_w_grp[l], pool_scale[l], attn_sinks[l],
                                      w_pool_out[l], w_attn_out[l], w_out[l])
        hp = layer_norm(ALPHA * hp + mp, ln2_g[l], ln2_b[l])
        hs = layer_norm(ALPHA * hs + ms, ln2_g[l], ln2_b[l])
        xp = ffn_half_step(hp, ffn2_w1[l], ffn2_w3[l], ffn2_w2[l], ln3_g[l], ln3_b[l])
        xs = ffn_half_step(hs, ffn2_w1[l], ffn2_w3[l], ffn2_w2[l], ln3_g[l], ln3_b[l])
        pu_l.append(pu); pk_l.append(pk); pv_l.append(pv)
        su_l.append(su); sk_l.append(sk); sv_l.append(sv)
    pool_u_prompt = jnp.stack(pu_l, axis=0)
    k_win_prompt = jnp.stack(pk_l, axis=0)
    v_win_prompt = jnp.stack(pv_l, axis=0)
    pool_u_sample = jnp.stack(su_l, axis=0)
    k_win_sample = jnp.stack(sk_l, axis=0)
    v_win_sample = jnp.stack(sv_l, axis=0)
    return (xp, xs, pool_u_prompt, k_win_prompt, v_win_prompt, pool_u_sample, k_win_sample, v_win_sample)
```

```cpp
#include <hip/hip_runtime.h>
#include <hip/hip_cooperative_groups.h>
#include <cstdio>
#include <cstdint>
namespace cg = cooperative_groups;
constexpr int MP = 16384, MS = 512, M = MP + MS, D = 1024, DFF = 2816, NUP = 2 * DFF, NIN = 3328, SEQ = 2048, NB = 8, NSEQ_S = 128;
constexpr float ALPHA = 1.189207115002721f;
constexpr float LN_EPS = 1e-5f;
constexpr size_t OFF_YP = 0, OFF_YS = (size_t)MP * D, OFF_PUP = OFF_YS + (size_t)MS * D, OFF_KP = OFF_PUP + 8 * 15 * 512, OFF_VP = OFF_KP + 8 * 128 * 128,
                 OFF_PUS = OFF_VP + 8 * 128 * 128, OFF_KS = OFF_PUS + (size_t)128 * 15 * 512, OFF_VS = OFF_KS + (size_t)128 * 128 * 128, OUT_TOTAL = OFF_VS + (size_t)128 * 128 * 128;
namespace pg8 {
#define PG8_LAS __attribute__((address_space(3)))
typedef unsigned short bf16_t;
typedef short bf16x8 __attribute__((ext_vector_type(8)));
typedef float f32x4 __attribute__((ext_vector_type(4)));
typedef unsigned u32x4 __attribute__((ext_vector_type(4)));
constexpr int BM = 256, BK = 64, HALF = 128, HTB = HALF * BK * 2  , STAGE_BYTES = 8 * HTB, NXCD = 8, WGM = 8;

__host__ __device__ __forceinline__ int lds_byte(int r, int c) { const int st = (r >> 4) * 2 + (c >> 5), rr = r & 15, cc = c & 31, ob = rr * 64 + cc * 2; return st * 1024 + (ob ^ (((ob >> 9) & 1) << 5)); }
__host__ __device__ __forceinline__ void stage_rc(int b, int& R, int& C) { const int st = b / 1024, sb = b % 1024, swz = sb ^ (((sb >> 9) & 1) << 5); R = (st >> 1) * 16 + swz / 64; C = (st & 1) * 32 + (swz % 64) / 2; }
__host__ __device__ __forceinline__ int perm32(int rho) { const int n = rho >> 4, i = rho & 15; return 8 * (i >> 2) + 4 * n + (i & 3); }

struct Unit { int pm, pn; };
struct Gemm { const bf16_t* A; const bf16_t* Bt; int M, N, K; };

struct StaticOrder {
    int nM, nN, nwg, G, c;
    __host__ __device__ void init(int M, int N, int G_, int c_) { nM = M / BM; nN = N / BM; nwg = nM * nN; G = G_; c = c_; }
    __host__ __device__ bool next(int i, Unit& u) const {
        const long L = (long)i * G + c; if (L >= nwg) return false;
        int wgid = (int)L; { const int q = nwg / NXCD, r = nwg % NXCD, xcd = wgid % NXCD, off = wgid / NXCD; wgid = (xcd < r ? xcd * (q + 1) : r * (q + 1) + (xcd - r) * q) + off; }
        const int nig = WGM * nN, gid = wgid / nig, fm = gid * WGM, gsz = (nM - fm) < WGM ? (nM - fm) : WGM;
        u.pm = fm + ((wgid % nig) % gsz); u.pn = (wgid % nig) / gsz; return true;
    }
    __device__ __forceinline__ void a_ready(const Unit&) const {}
    __device__ __forceinline__ void done(const Unit&) const {}
};

__device__ __forceinline__ unsigned cvt_pk_bf16(float lo, float hi) { unsigned r; asm volatile("v_cvt_pk_bf16_f32 %0, %1, %2" : "=v"(r) : "v"(lo), "v"(hi)); return r; }
typedef float f32x2 __attribute__((ext_vector_type(2)));
__device__ __forceinline__ unsigned pkbf(float lo, float hi) { typedef float f2_t __attribute__((ext_vector_type(2))); typedef __bf16 b2_t __attribute__((ext_vector_type(2))); f2_t v = {lo, hi}; b2_t b = __builtin_convertvector(v, b2_t); return __builtin_bit_cast(unsigned, b); }
__device__ __forceinline__ float bflo(unsigned w) { return __uint_as_float(w << 16); }
__device__ __forceinline__ float bfhi(unsigned w) { return __uint_as_float(w & 0xffff0000u); }
__device__ __forceinline__ float sigmoidf_(float a) { return __builtin_amdgcn_rcpf(1.0f + __builtin_amdgcn_exp2f(-1.4426950408889634f * a)); }

struct EpiSwiGLU {
    static constexpr bool PERM = true, AFTER_DRAIN = false;
    bf16_t* H; int ldh;
    __device__ __forceinline__ void operator()(const f32x4 (&acc)[2][2][4][2], const Unit& u, int wr, int wc, int fr, int fq) const {
        const int row0 = u.pm * BM + wr * 64 + fr, col0 = u.pn * 128 + wc * 32 + 8 * fq;
#pragma unroll
        for (int ai = 0; ai < 2; ++ai)
#pragma unroll
            for (int m = 0; m < 4; ++m) {
                bf16_t* rowp = H + (size_t)(row0 + ai * HALF + m * 16) * ldh + col0;
                float h[8];
#pragma unroll
                for (int n = 0; n < 2; ++n)
#pragma unroll
                    for (int e = 0; e < 4; ++e) { const float a = acc[ai][0][m][n][e], b = acc[ai][1][m][n][e]; h[n * 4 + e] = a * sigmoidf_(a) * b; }
                u32x4 w; w.x = pkbf(h[0], h[1]); w.y = pkbf(h[2], h[3]); w.z = pkbf(h[4], h[5]); w.w = pkbf(h[6], h[7]);
                *(u32x4*)rowp = w;
            }
    }
};
struct EpiResid {
    static constexpr bool PERM = false, AFTER_DRAIN = false;
    const float* baseP; const float* baseS; float* out; float alpha, scale;
    __device__ __forceinline__ void operator()(const f32x4 (&acc)[2][2][4][2], const Unit& u, int wr, int wc, int fr, int fq) const {
        const int row0 = u.pm * BM + wr * 64 + fr, col0 = u.pn * BM + wc * 32 + 4 * fq;
        const bool smp = u.pm >= 64;
#pragma unroll
        for (int ai = 0; ai < 2; ++ai)
#pragma unroll
            for (int m = 0; m < 4; ++m) {
                const int row = row0 + ai * HALF + m * 16;
                const float* bp = smp ? baseS + (size_t)(row - 16384) * 1024 + col0 : baseP + (size_t)row * 1024 + col0;
                float* op = out + (size_t)row * 1024 + col0;
                f32x4 b[2][2];
#pragma unroll
                for (int bj = 0; bj < 2; ++bj)
#pragma unroll
                    for (int n = 0; n < 2; ++n) b[bj][n] = *(const f32x4*)(bp + bj * HALF + n * 16);
#pragma unroll
                for (int bj = 0; bj < 2; ++bj)
#pragma unroll
                    for (int n = 0; n < 2; ++n) *(f32x4*)(op + bj * HALF + n * 16) = b[bj][n] * alpha + acc[ai][bj][m][n] * scale;
                asm volatile("" ::: "memory");
            }
    }
};
struct EpiInProj {
    static constexpr bool PERM = true, AFTER_DRAIN = false;
    bf16_t *U, *Q, *Kb, *Vb, *G; const float* ropec; const float* ropes; float* dout;
    __device__ __forceinline__ void operator()(const f32x4 (&acc)[2][2][4][2], const Unit& u, int wr, int wc, int fr, int fq) const {
        const int row0 = u.pm * BM + wr * 64 + fr; const bool smp = u.pm >= 64; const bool lastp = (u.pm & 7) == 7 && !smp;
        if (u.pn < 2) {
            const int col0 = u.pn * 256 + wc * 32 + 8 * fq;
#pragma unroll
            for (int ai = 0; ai < 2; ++ai)
#pragma unroll
                for (int m = 0; m < 4; ++m) { const int row = row0 + ai * HALF + m * 16;
#pragma unroll
                    for (int bj = 0; bj < 2; ++bj) { const f32x4 v0 = acc[ai][bj][m][0], v1 = acc[ai][bj][m][1];
                        u32x4 w; w.x = pkbf(v0[0], v0[1]); w.y = pkbf(v0[2], v0[3]); w.z = pkbf(v1[0], v1[1]); w.w = pkbf(v1[2], v1[3]);
                        *(u32x4*)(U + (size_t)row * 512 + col0 + bj * HALF) = w;
                        float* dst = nullptr;
                        if (smp) { const int s = (row - 16384) >> 2, tt = row & 3; dst = dout + OFF_PUS + ((size_t)s * 15 + 11 + tt) * 512 + col0 + bj * HALF; }
                        else if (lastp && ai == 1) { const int t = row & 2047; if (t >= 2033) dst = dout + OFF_PUP + ((size_t)(row >> 11) * 15 + (t - 2033)) * 512 + col0 + bj * HALF; }
                        if (dst) { *(f32x4*)dst = v0; *(f32x4*)(dst + 4) = v1; } } }
        } else if (u.pn < 5) {
            const bool isq = u.pn < 4, isk = !isq && wc < 2;
            const int r0 = 8 * fq;
            if (isq || isk) {
                const int head = isq ? (u.pn - 2) * 4 + wc : wc;
#pragma unroll
                for (int ai = 0; ai < 2; ++ai)
#pragma unroll
                    for (int m = 0; m < 4; ++m) { const int row = row0 + ai * HALF + m * 16;
                        const int pidx = smp ? 2048 + (row & 3) : (row & 2047);
                        const f32x4 c0 = *(const f32x4*)(ropec + pidx * 32 + r0), c1 = *(const f32x4*)(ropec + pidx * 32 + r0 + 4);
                        const f32x4 s0 = *(const f32x4*)(ropes + pidx * 32 + r0), s1 = *(const f32x4*)(ropes + pidx * 32 + r0 + 4);
                        const f32x4 xa0 = acc[ai][0][m][0], xa1 = acc[ai][0][m][1], xb0 = acc[ai][1][m][0], xb1 = acc[ai][1][m][1];
                        const f32x4 o10 = xa0 * c0 - xb0 * s0, o11 = xa1 * c1 - xb1 * s1, o20 = xa0 * s0 + xb0 * c0, o21 = xa1 * s1 + xb1 * c1;
                        u32x4 w1, w2; w1.x = pkbf(o10[0], o10[1]); w1.y = pkbf(o10[2], o10[3]); w1.z = pkbf(o11[0], o11[1]); w1.w = pkbf(o11[2], o11[3]);
                        w2.x = pkbf(o20[0], o20[1]); w2.y = pkbf(o20[2], o20[3]); w2.z = pkbf(o21[0], o21[1]); w2.w = pkbf(o21[2], o21[3]);
                        if (isq) { bf16_t* qp = Q + (size_t)row * 512 + head * 64 + r0; *(u32x4*)qp = w1; *(u32x4*)(qp + 32) = w2; }
                        else { bf16_t* kp = Kb + (size_t)row * 128 + head * 64 + r0; *(u32x4*)kp = w1; *(u32x4*)(kp + 32) = w2;
                            float* dst = nullptr;
                            if (smp) { const int s = (row - 16384) >> 2, tt = row & 3; dst = dout + OFF_KS + (((size_t)s * 128 + 124 + tt) * 2 + head) * 64 + r0; }
                            else if (lastp && ai == 1) { const int t = row & 2047; dst = dout + OFF_KP + (((size_t)(row >> 11) * 128 + (t - 1920)) * 2 + head) * 64 + r0; }
                            if (dst) { *(f32x4*)dst = o10; *(f32x4*)(dst + 4) = o11; *(f32x4*)(dst + 32) = o20; *(f32x4*)(dst + 36) = o21; } } }
            } else {
                const int head = wc - 2;
#pragma unroll
                for (int ai = 0; ai < 2; ++ai)
#pragma unroll
                    for (int m = 0; m < 4; ++m) { const int row = row0 + ai * HALF + m * 16;
#pragma unroll
                        for (int bj = 0; bj < 2; ++bj) { const f32x4 v0 = acc[ai][bj][m][0], v1 = acc[ai][bj][m][1];
                            u32x4 w; w.x = pkbf(v0[0], v0[1]); w.y = pkbf(v0[2], v0[3]); w.z = pkbf(v1[0], v1[1]); w.w = pkbf(v1[2], v1[3]);
                            *(u32x4*)(Vb + (size_t)row * 128 + head * 64 + bj * 32 + r0) = w;
                            float* dst = nullptr;
                            if (smp) { const int s = (row - 16384) >> 2, tt = row & 3; dst = dout + OFF_VS + (((size_t)s * 128 + 124 + tt) * 2 + head) * 64 + bj * 32 + r0; }
                            else if (lastp && ai == 1) { const int t = row & 2047; dst = dout + OFF_VP + (((size_t)(row >> 11) * 128 + (t - 1920)) * 2 + head) * 64 + bj * 32 + r0; }
                            if (dst) { *(f32x4*)dst = v0; *(f32x4*)(dst + 4) = v1; } } }
            }
        } else {
            const int col0 = (u.pn - 5) * 256 + wc * 32 + 8 * fq;
#pragma unroll
            for (int ai = 0; ai < 2; ++ai)
#pragma unroll
                for (int m = 0; m < 4; ++m) { const int row = row0 + ai * HALF + m * 16;
#pragma unroll
                    for (int bj = 0; bj < 2; ++bj) { const f32x4 v0 = acc[ai][bj][m][0], v1 = acc[ai][bj][m][1];
                        u32x4 w; w.x = pkbf(sigmoidf_(v0[0]), sigmoidf_(v0[1])); w.y = pkbf(sigmoidf_(v0[2]), sigmoidf_(v0[3])); w.z = pkbf(sigmoidf_(v1[0]), sigmoidf_(v1[1])); w.w = pkbf(sigmoidf_(v1[2]), sigmoidf_(v1[3]));
                        *(u32x4*)(G + (size_t)row * 2048 + col0 + bj * HALF) = w; } }
        }
    }
};
template <bool FIRST> struct EpiMerge {
    static constexpr bool PERM = true, AFTER_DRAIN = false;
    const bf16_t* G; bf16_t* MP;
    __device__ __forceinline__ void operator()(const f32x4 (&acc)[2][2][4][2], const Unit& u, int wr, int wc, int fr, int fq) const {
        const int row0 = u.pm * BM + wr * 64 + fr, col0 = u.pn * BM + wc * 32 + 8 * fq;
#pragma unroll
        for (int ai = 0; ai < 2; ++ai)
#pragma unroll
            for (int m = 0; m < 4; ++m) { const int row = row0 + ai * HALF + m * 16;
#pragma unroll
                for (int bj = 0; bj < 2; ++bj) {
                    const u32x4 g = *(const u32x4*)(G + (size_t)row * 2048 + (FIRST ? 0 : 1024) + col0 + bj * HALF);
                    bf16_t* mp = MP + (size_t)row * 1024 + col0 + bj * HALF;
                    const f32x4 v0 = acc[ai][bj][m][0], v1 = acc[ai][bj][m][1];
                    float o[8] = { v0[0] * bflo(g.x), v0[1] * bfhi(g.x), v0[2] * bflo(g.y), v0[3] * bfhi(g.y), v1[0] * bflo(g.z), v1[1] * bfhi(g.z), v1[2] * bflo(g.w), v1[3] * bfhi(g.w) };
                    if (!FIRST) { const u32x4 p = *(const u32x4*)mp; o[0] += bflo(p.x); o[1] += bfhi(p.x); o[2] += bflo(p.y); o[3] += bfhi(p.y); o[4] += bflo(p.z); o[5] += bfhi(p.z); o[6] += bflo(p.w); o[7] += bfhi(p.w); }
                    u32x4 w; w.x = pkbf(o[0], o[1]); w.y = pkbf(o[2], o[3]); w.z = pkbf(o[4], o[5]); w.w = pkbf(o[6], o[7]);
                    *(u32x4*)mp = w; }
                asm volatile("" ::: "memory"); }
    }
};
template <class Epi, class Sched, bool ALIGN_EPI = false, bool SP2 = false>
__device__ __forceinline__ void gemm_phase(PG8_LAS unsigned char* lds, const Gemm g, const Sched& S, const Epi& E) {
    const int tid = threadIdx.x, wid = __builtin_amdgcn_readfirstlane(tid >> 6), lane = tid & 63, wr = wid >> 2, wc = wid & 3, fr = lane & 15, fq = lane >> 4;
    const int K = g.K, nt = K / BK;
    unsigned voffA[2], voffB[2];
#pragma unroll
    for (int i = 0; i < 2; ++i) { int R, C; stage_rc(tid * 16 + i * 8192, R, C); const int Rb = Epi::PERM ? ((R & ~31) + perm32(R & 31)) : R;
        voffA[i] = (unsigned)(R * K + C) * 2u; voffB[i] = (unsigned)(Rb * K + C) * 2u; }
    const size_t kstep = (size_t)(BK * 2);
    const size_t hstep = (size_t)HALF * K * 2;
    const size_t tstep = 2 * hstep;
    const unsigned ldsw = (unsigned)wid * 1024u;
    const int aoff = lds_byte(wr * 64 + fr, fq * 8), boff = lds_byte(wc * 32 + fr, fq * 8);
#define PG8_SA(b, h) (((b) * 2 + (h)) * HTB)
#define PG8_SB(b, h) ((4 + (b) * 2 + (h)) * HTB)
#define PG8_STAGE(bufoff, gbase, voff) do { _Pragma("unroll") for (int _i = 0; _i < 2; ++_i) \
        __builtin_amdgcn_global_load_lds((const unsigned*)((const char*)(gbase) + (voff)[_i]), (PG8_LAS unsigned*)(lds + (bufoff) + ldsw + _i * 8192), 16, 0, 0); } while (0)
#define PG8_LDA(dst, b, h) do { _Pragma("unroll") for (int m = 0; m < 4; ++m) _Pragma("unroll") for (int k = 0; k < 2; ++k) dst[m][k] = *(const PG8_LAS bf16x8*)(lds + PG8_SA(b, h) + aoff + m * 2048 + k * 1024); } while (0)
#define PG8_LDB(dst, b, h) do { _Pragma("unroll") for (int n = 0; n < 2; ++n) _Pragma("unroll") for (int k = 0; k < 2; ++k) dst[n][k] = *(const PG8_LAS bf16x8*)(lds + PG8_SB(b, h) + boff + n * 2048 + k * 1024); } while (0)
#define PG8_MMA(ai, bj, At, Bt) do { __builtin_amdgcn_s_setprio(1); _Pragma("unroll") for (int m = 0; m < 4; ++m) _Pragma("unroll") for (int n = 0; n < 2; ++n) _Pragma("unroll") for (int k = 0; k < 2; ++k) \
        acc[ai][bj][m][n] = __builtin_amdgcn_mfma_f32_16x16x32_bf16(Bt[n][k], At[m][k], acc[ai][bj][m][n], 0, 0, 0); __builtin_amdgcn_s_setprio(0); } while (0)
#define PG8_WAIT_V(n) asm volatile("s_waitcnt vmcnt(" #n ")" ::: "memory")
#define PG8_WAIT_L(n) asm volatile("s_waitcnt lgkmcnt(" #n ")" ::: "memory")
#define PG8_BAR __builtin_amdgcn_s_barrier()
#define PG8_SCHED __builtin_amdgcn_sched_barrier(0)
    Unit cur, nxt; int ui = 0;
    if (!S.next(0, cur)) return;
    f32x4 acc[2][2][4][2];
#pragma unroll
    for (int a = 0; a < 2; ++a)
#pragma unroll
        for (int b = 0; b < 2; ++b)
#pragma unroll
            for (int m = 0; m < 4; ++m)
#pragma unroll
                for (int n = 0; n < 2; ++n) acc[a][b][m][n] = (f32x4){0.f, 0.f, 0.f, 0.f};
    bf16x8 At[4][2], B0[2][2], B1[2][2];
    const char* cA = (const char*)g.A + (size_t)cur.pm * tstep; const char* cB = (const char*)g.Bt + (size_t)cur.pn * tstep;
    S.a_ready(cur);
    if constexpr (SP2) {
        PG8_STAGE(PG8_SB(0, 0), cB, voffB); PG8_STAGE(PG8_SB(0, 1), cB + hstep, voffB); PG8_STAGE(PG8_SA(0, 0), cA, voffA); PG8_STAGE(PG8_SA(0, 1), cA + hstep, voffA);
        if (wr == 1) PG8_BAR;
        PG8_WAIT_V(2); PG8_BAR;
        PG8_STAGE(PG8_SB(1, 0), cB + kstep, voffB); PG8_STAGE(PG8_SA(1, 0), cA + kstep, voffA); PG8_STAGE(PG8_SB(1, 1), cB + hstep + kstep, voffB);
        PG8_WAIT_V(6); PG8_BAR;
    } else {
        PG8_STAGE(PG8_SB(0, 0), cB, voffB); PG8_STAGE(PG8_SA(0, 0), cA, voffA); PG8_STAGE(PG8_SB(0, 1), cB + hstep, voffB); PG8_STAGE(PG8_SA(0, 1), cA + hstep, voffA);
        if (wr == 1) PG8_BAR;
        PG8_WAIT_V(4); PG8_BAR;
        PG8_STAGE(PG8_SB(1, 0), cB + kstep, voffB); PG8_STAGE(PG8_SA(1, 0), cA + kstep, voffA); PG8_STAGE(PG8_SB(1, 1), cB + hstep + kstep, voffB);
        PG8_WAIT_V(6); PG8_BAR;
    }
    for (;;) {
        const bool has_next = S.next(ui + 1, nxt);
        const char* nA = has_next ? (const char*)g.A + (size_t)nxt.pm * tstep : cA; const char* nB = has_next ? (const char*)g.Bt + (size_t)nxt.pn * tstep : cB;
        for (int t = 0; t < nt; t += 2) {
            const bool last = (t == nt - 2);
            const char* a1 = cA + (size_t)(t + 1) * kstep;
            const char* a2 = last ? nA : cA + (size_t)(t + 2) * kstep; const char* b2 = last ? nB : cB + (size_t)(t + 2) * kstep;
            const char* a3 = a2 + kstep; const char* b3 = b2 + kstep;
            if (last && has_next) S.a_ready(nxt);
            if constexpr (SP2) {
            PG8_LDB(B0, 0, 0); PG8_LDB(B1, 0, 1); PG8_SCHED; PG8_LDA(At, 0, 0); PG8_STAGE(PG8_SA(1, 1), a1 + hstep, voffA);
            PG8_WAIT_V(8); PG8_WAIT_L(0); PG8_BAR; PG8_MMA(0, 0, At, B0); PG8_MMA(0, 1, At, B1); PG8_BAR; PG8_SCHED;
            PG8_LDA(At, 0, 1); PG8_STAGE(PG8_SB(0, 0), b2, voffB); PG8_STAGE(PG8_SB(0, 1), b2 + hstep, voffB); PG8_STAGE(PG8_SA(0, 0), a2, voffA);
            PG8_WAIT_V(8); PG8_WAIT_L(0); PG8_BAR; PG8_MMA(1, 0, At, B0); PG8_MMA(1, 1, At, B1); PG8_BAR; PG8_SCHED;
            PG8_LDB(B0, 1, 0); PG8_LDB(B1, 1, 1); PG8_SCHED; PG8_LDA(At, 1, 0); PG8_STAGE(PG8_SA(0, 1), a2 + hstep, voffA);
            PG8_WAIT_V(8); PG8_WAIT_L(0); PG8_BAR; PG8_MMA(0, 0, At, B0); PG8_MMA(0, 1, At, B1); PG8_BAR; PG8_SCHED;
            PG8_LDA(At, 1, 1); PG8_STAGE(PG8_SB(1, 0), b3, voffB); PG8_STAGE(PG8_SB(1, 1), b3 + hstep, voffB); PG8_STAGE(PG8_SA(1, 0), a3, voffA);
            PG8_WAIT_V(8); PG8_WAIT_L(0); PG8_BAR; PG8_MMA(1, 0, At, B0); PG8_MMA(1, 1, At, B1); PG8_BAR; PG8_SCHED;
            } else {
            PG8_LDB(B0, 0, 0); PG8_SCHED; PG8_LDA(At, 0, 0); PG8_STAGE(PG8_SA(1, 1), a1 + hstep, voffA);
            PG8_WAIT_L(8); PG8_BAR; PG8_WAIT_L(0); PG8_MMA(0, 0, At, B0); PG8_BAR; PG8_SCHED;
            PG8_LDB(B1, 0, 1); PG8_STAGE(PG8_SB(0, 0), b2, voffB);
            PG8_BAR; PG8_WAIT_L(0); PG8_MMA(0, 1, At, B1); PG8_BAR;
            PG8_LDA(At, 0, 1); PG8_STAGE(PG8_SA(0, 0), a2, voffA);
            PG8_BAR; PG8_WAIT_L(0); PG8_MMA(1, 0, At, B0); PG8_BAR; PG8_SCHED;
            PG8_STAGE(PG8_SB(0, 1), b2 + hstep, voffB);
            PG8_WAIT_V(6); PG8_BAR; PG8_MMA(1, 1, At, B1); PG8_BAR;
            PG8_LDB(B0, 1, 0); PG8_SCHED; PG8_LDA(At, 1, 0); PG8_STAGE(PG8_SA(0, 1), a2 + hstep, voffA);
            PG8_WAIT_L(8); PG8_BAR; PG8_WAIT_L(0); PG8_MMA(0, 0, At, B0); PG8_BAR; PG8_SCHED;
            PG8_LDB(B1, 1, 1); PG8_STAGE(PG8_SB(1, 0), b3, voffB);
            PG8_BAR; PG8_WAIT_L(0); PG8_MMA(0, 1, At, B1); PG8_BAR;
            PG8_LDA(At, 1, 1); PG8_STAGE(PG8_SA(1, 0), a3, voffA);
            PG8_BAR; PG8_WAIT_L(0); PG8_MMA(1, 0, At, B0); PG8_BAR; PG8_SCHED;
            PG8_STAGE(PG8_SB(1, 1), b3 + hstep, voffB);
            PG8_WAIT_V(6); PG8_BAR; PG8_MMA(1, 1, At, B1); PG8_BAR;
            }
        }
        if constexpr (ALIGN_EPI) { if (wr == 0) PG8_BAR; }
        if constexpr (!Epi::AFTER_DRAIN) { E(acc, cur, wr, wc, fr, fq); S.done(cur); }
        if (!has_next) break;
#pragma unroll
        for (int a = 0; a < 2; ++a)
#pragma unroll
            for (int b = 0; b < 2; ++b)
#pragma unroll
                for (int m = 0; m < 4; ++m)
#pragma unroll
                    for (int n = 0; n < 2; ++n) acc[a][b][m][n] = (f32x4){0.f, 0.f, 0.f, 0.f};
        cur = nxt; cA = nA; cB = nB; ++ui;
        if constexpr (ALIGN_EPI) { if (wr == 1) PG8_BAR; }
    }
    PG8_WAIT_V(0);
    if constexpr (!ALIGN_EPI) { if (wr == 0) PG8_BAR; }
    PG8_BAR;
    if constexpr (Epi::AFTER_DRAIN) { E.fused(acc, cur, wr, wc, fr, fq, lds, wid, lane); S.done(cur); }
#undef PG8_SA
#undef PG8_SB
#undef PG8_STAGE
#undef PG8_LDA
#undef PG8_LDB
#undef PG8_MMA
#undef PG8_WAIT_V
#undef PG8_WAIT_L
#undef PG8_BAR
#undef PG8_SCHED
}
}
constexpr int NWAVES = 8, NTHR = 512;
constexpr size_t MiB = 1u << 20;
constexpr size_t WS_CTL = 0, CTL_BYTES = MiB;
constexpr size_t WS_ROPEC = 1 * MiB, WS_ROPES = WS_ROPEC + 512 * 1024;
constexpr size_t WS_W13A = 2 * MiB, WS_W2A = 13 * MiB, WS_W13B = WS_W2A + 5632 * 1024, WS_W2B = WS_W13B + 11 * MiB;
constexpr size_t WS_WIN = 35 * MiB, WS_WP = WS_WIN + 6656 * 1024, WS_WA = WS_WP + MiB, WS_WOUT = WS_WA + MiB, WS_WG = WS_WOUT + 2 * MiB;
constexpr size_t WS_XN = 46 * MiB;
constexpr size_t WS_R = 79 * MiB;
constexpr size_t WS_BIG = 145 * MiB;
constexpr size_t WS_G = WS_BIG, WS_U = WS_G + (size_t)M * 2048 * 2, WS_K = WS_U + (size_t)M * 512 * 2, WS_V = WS_K + (size_t)M * 128 * 2;
constexpr size_t WS_Q = WS_BIG + (size_t)M * DFF * 2;
constexpr size_t WS_END = WS_Q + (size_t)M * 512 * 2;
static_assert(WS_V + (size_t)M * 128 * 2 == WS_Q && WS_END <= 256 * MiB && WS_W2B + 5632 * 1024 == WS_WIN && WS_WG + 131072 <= WS_XN, "d_ws map");
constexpr int LDS_BYTES = 147456;
constexpr int NPHASE = 12;

#define LAS __attribute__((address_space(3)))
typedef unsigned short bf16;
typedef float f32x4 __attribute__((ext_vector_type(4)));
typedef float f32x16 __attribute__((ext_vector_type(16)));
typedef short bf16x8 __attribute__((ext_vector_type(8)));
typedef short s16x4 __attribute__((ext_vector_type(4)));
typedef unsigned u32x4 __attribute__((ext_vector_type(4)));
typedef unsigned u32x2 __attribute__((ext_vector_type(2)));
using pg8::pkbf; using pg8::bflo; using pg8::bfhi;
#define LDS_WAIT() asm volatile("s_waitcnt lgkmcnt(0)" ::: "memory")

__device__ __forceinline__ float wave_sum(float v) {
#pragma unroll
    for (int o = 1; o < 64; o <<= 1) v += __shfl_xor(v, o);
    return v;
}
__device__ __forceinline__ float wave_max(float v) {
#pragma unroll
    for (int o = 1; o < 64; o <<= 1) v = fmaxf(v, __shfl_xor(v, o));
    return v;
}
__device__ __forceinline__ int crow(int r, int hi) { return (r & 3) + 8 * (r >> 2) + 4 * hi; }

__device__ __forceinline__ int maprow(int mode, int n0) {
    if (mode == 1) return 256 * (n0 >> 7) + (n0 & 127);
    if (mode == 2) return 256 * (n0 >> 7) + 128 + (n0 & 127);
    if (mode == 3) { const int pn = n0 >> 8; if (pn >= 2 && pn <= 4) { const int w = n0 & 255; return 256 * pn + 128 * ((w >> 5) & 1) + 32 * (w >> 6); } return n0; }
    return n0;
}
__device__ __forceinline__ void transpose_item(const float* W, int K, int N, bf16* WT, int mode, LAS float* scr, int item, int lane) {
    const int nblk = N / 32, kb = item / nblk, nb = item % nblk, k0 = 64 * kb, n0 = 32 * nb;
#pragma unroll 8
    for (int i = 0; i < 32; ++i) { const int kk = 2 * i + (lane >> 5); scr[kk * 33 + (lane & 31)] = W[(size_t)(k0 + kk) * N + n0 + (lane & 31)]; }
    LDS_WAIT(); asm volatile("" ::: "memory");
    const int c = lane & 7, R0 = maprow(mode, n0);
#pragma unroll
    for (int j = 0; j < 4; ++j) { const int n = (lane >> 3) + 8 * j; const LAS float* s = scr + (8 * c) * 33 + n;
        u32x4 o; o.x = pkbf(s[0 * 33], s[1 * 33]); o.y = pkbf(s[2 * 33], s[3 * 33]); o.z = pkbf(s[4 * 33], s[5 * 33]); o.w = pkbf(s[6 * 33], s[7 * 33]);
        *(u32x4*)(WT + (size_t)(R0 + n) * K + k0 + 8 * c) = o; }
    LDS_WAIT(); asm volatile("" ::: "memory");
}

struct Args { const float* in[24]; float* out; unsigned char* ws; int ph_lo, ph_hi; };

__device__ __forceinline__ void p0_prologue(const Args& a, LAS unsigned char* lds, int vcu, int G, int wave, int lane, int tid) {
    unsigned char* ws = a.ws;
    LAS float* scr = (LAS float*)(lds + wave * 16384);
    const int gw = vcu * NWAVES + wave, NGW = G * NWAVES;
    constexpr int I_UP = (D / 64) * (DFF / 32), I_DN = (DFF / 64) * (D / 32), I_IN = (D / 64) * (NIN / 32), I_PO = (512 / 64) * (D / 32), I_OUT = (D / 64) * (D / 32), I_G = 4 * (128 / 64) * (128 / 32);
    constexpr int NITEMS = 4 * I_UP + 2 * I_DN + I_IN + 2 * I_PO + I_OUT + I_G;
    for (int it = gw; it < NITEMS; it += NGW) {
        int r = it;
        if (r < I_UP) { transpose_item(a.in[12], D, DFF, (bf16*)(ws + WS_W13A), 1, scr, r, lane); continue; } r -= I_UP;
        if (r < I_UP) { transpose_item(a.in[13], D, DFF, (bf16*)(ws + WS_W13A), 2, scr, r, lane); continue; } r -= I_UP;
        if (r < I_DN) { transpose_item(a.in[14], DFF, D, (bf16*)(ws + WS_W2A), 0, scr, r, lane); continue; } r -= I_DN;
        if (r < I_UP) { transpose_item(a.in[15], D, DFF, (bf16*)(ws + WS_W13B), 1, scr, r, lane); continue; } r -= I_UP;
        if (r < I_UP) { transpose_item(a.in[16], D, DFF, (bf16*)(ws + WS_W13B), 2, scr, r, lane); continue; } r -= I_UP;
        if (r < I_DN) { transpose_item(a.in[17], DFF, D, (bf16*)(ws + WS_W2B), 0, scr, r, lane); continue; } r -= I_DN;
        if (r < I_IN) { transpose_item(a.in[5], D, NIN, (bf16*)(ws + WS_WIN), 3, scr, r, lane); continue; } r -= I_IN;
        if (r < I_PO) { transpose_item(a.in[9], 512, D, (bf16*)(ws + WS_WP), 0, scr, r, lane); continue; } r -= I_PO;
        if (r < I_PO) { transpose_item(a.in[10], 512, D, (bf16*)(ws + WS_WA), 0, scr, r, lane); continue; } r -= I_PO;
        if (r < I_OUT) { transpose_item(a.in[11], D, D, (bf16*)(ws + WS_WOUT), 0, scr, r, lane); continue; } r -= I_OUT;
        { const int g = r >> 3; transpose_item(a.in[6] + g * 16384, 128, 128, (bf16*)(ws + WS_WG) + g * 16384, 0, scr, r & 7, lane); }
    }
    bf16* XN = (bf16*)(ws + WS_XN);
    for (int m = gw; m < M; m += NGW) {
        const float* xr = (m < MP) ? a.in[0] + (size_t)m * D : a.in[1] + (size_t)(m - MP) * D;
        const f32x4* x4 = (const f32x4*)xr + lane; u32x2* o8 = (u32x2*)(XN + (size_t)m * D) + lane;
#pragma unroll
        for (int j = 0; j < 4; ++j) { const f32x4 v = x4[64 * j]; u32x2 o; o.x = pkbf(v[0], v[1]); o.y = pkbf(v[2], v[3]); o8[64 * j] = o; }
    }
    const int gt = vcu * NTHR + tid, NGT = G * NTHR;
    float* rc = (float*)(ws + WS_ROPEC); float* rs = (float*)(ws + WS_ROPES);
    for (int i = gt; i < 2052 * 32; i += NGT) { const int p = i >> 5, r = i & 31; const int pos = p < 2048 ? p : 8192 + (p - 2048);
        const double freq = exp2(-(double)r * (13.287712379549449 / 32.0)); const double ang = (double)pos * freq; rc[i] = (float)cos(ang); rs[i] = (float)sin(ang); }
    { const f32x4* sk = (const f32x4*)a.in[3]; const f32x4* sv = (const f32x4*)a.in[4]; f32x4* dk = (f32x4*)(a.out + OFF_KS); f32x4* dv = (f32x4*)(a.out + OFF_VS);
      for (int i = gt; i < 128 * 3968; i += NGT) { const int s = i / 3968, j = i - s * 3968; dk[s * 4096 + j] = sk[s * 4096 + 128 + j]; dv[s * 4096 + j] = sv[s * 4096 + 128 + j]; }
      const f32x4* su = (const f32x4*)a.in[2]; f32x4* du = (f32x4*)(a.out + OFF_PUS);
      for (int i = gt; i < 128 * 1408; i += NGT) { const int s = i / 1408, j = i - s * 1408; du[s * 1920 + j] = su[s * 1920 + 512 + j]; } }
}

__device__ __forceinline__ void ln_rows(const float* Rin, const float* gam, const float* bet, float* fout, bf16* bout, int gw, int NGW, int lane) {
    f32x4 gv[4], bv[4];
#pragma unroll
    for (int j = 0; j < 4; ++j) { gv[j] = ((const f32x4*)gam)[lane + 64 * j]; bv[j] = ((const f32x4*)bet)[lane + 64 * j]; }
    for (int m = gw; m < M; m += NGW) {
        const f32x4* xr = (const f32x4*)(Rin + (size_t)m * D) + lane;
        f32x4 v[4]; float s = 0.f;
#pragma unroll
        for (int j = 0; j < 4; ++j) { v[j] = xr[64 * j]; s += (v[j][0] + v[j][1]) + (v[j][2] + v[j][3]); }
        const float mean = wave_sum(s) * (1.f / D); float s2 = 0.f;
#pragma unroll
        for (int j = 0; j < 4; ++j) { v[j] = v[j] - mean; s2 += (v[j][0] * v[j][0] + v[j][1] * v[j][1]) + (v[j][2] * v[j][2] + v[j][3] * v[j][3]); }
        const float rstd = 1.0f / sqrtf(wave_sum(s2) * (1.f / D) + LN_EPS);
        f32x4* fo = (f32x4*)(fout + (size_t)m * D) + lane;
#pragma unroll
        for (int j = 0; j < 4; ++j) { const f32x4 y = v[j] * rstd * gv[j] + bv[j]; fo[64 * j] = y;
            if (bout) { u32x2 o; o.x = pkbf(y[0], y[1]); o.y = pkbf(y[2], y[3]); ((u32x2*)(bout + (size_t)m * D) + lane)[64 * j] = o; } }
    }
}
constexpr int ZP = 136;
template <int G_> __device__ __forceinline__ void pool_fill_prompt(const bf16* U, int b, int tt, int lane, LAS unsigned* z) {
    constexpr int W = 2 << G_, NR = 31 + W;
    const int t0 = tt * 32;
    const unsigned* up = (const unsigned*)(U + (size_t)b * SEQ * 512 + G_ * 128) + lane;
    unsigned ur[NR];
#pragma unroll
    for (int i = 0; i < NR; ++i) { const int t = t0 - (W - 1) + i; ur[i] = (t >= 0) ? up[(size_t)t * 256] : 0u; }
    float s0 = 0.f, s1 = 0.f;
#pragma unroll
    for (int i = 0; i < W - 1; ++i) { s0 += bflo(ur[i]); s1 += bfhi(ur[i]); }
#pragma unroll
    for (int j = 0; j < 32; ++j) { const int t = t0 + j; const float c0 = bflo(ur[W - 1 + j]), c1 = bfhi(ur[W - 1 + j]); s0 += c0; s1 += c1;
        const float cnt = (float)((t + 1 < W) ? t + 1 : W);
        z[j * (ZP / 2) + lane] = pkbf(s0 / cnt - c0, s1 / cnt - c1);
        s0 -= bflo(ur[j]); s1 -= bfhi(ur[j]); }
}
template <int G_> __device__ __forceinline__ void pool_fill_sample(const bf16* U, const float* ctx, int sg, int lane, LAS unsigned* z) {
    constexpr int W = 2 << G_;
#pragma unroll 1
    for (int q = 0; q < 8; ++q) { const int s = sg * 8 + q;
        const float* cp = ctx + (size_t)s * 15 * 512 + G_ * 128 + 2 * lane;
        float c0[W - 1], c1[W - 1];
#pragma unroll
        for (int i = 0; i < W - 1; ++i) { const float2 v = *(const float2*)(cp + (size_t)(15 - (W - 1) + i) * 512); c0[i] = v.x; c1[i] = v.y; }
        unsigned un[4];
#pragma unroll
        for (int t = 0; t < 4; ++t) un[t] = ((const unsigned*)(U + (size_t)(MP + 4 * s + t) * 512 + G_ * 128))[lane];
        float s0 = 0.f, s1 = 0.f;
#pragma unroll
        for (int i = 0; i < W - 1; ++i) { s0 += c0[i]; s1 += c1[i]; }
#pragma unroll
        for (int t = 0; t < 4; ++t) { const float u0 = bflo(un[t]), u1 = bfhi(un[t]); s0 += u0; s1 += u1;
            z[(q * 4 + t) * (ZP / 2) + lane] = pkbf(s0 * (1.0f / W) - u0, s1 * (1.0f / W) - u1);
            if (t < W - 1) { s0 -= c0[t]; s1 -= c1[t]; } else { s0 -= bflo(un[t - (W - 1) < 0 ? 0 : t - (W - 1)]); s1 -= bfhi(un[t - (W - 1) < 0 ? 0 : t - (W - 1)]); } } }
}
__device__ __forceinline__ void pool_mma(const bf16* WgT, const float* scale, bf16* PZ, int g, int row_base, int lane, const LAS unsigned char* z) {
    const int r32 = lane & 31, hh = lane >> 5;
    bf16x8 zf[8];
#pragma unroll
    for (int s = 0; s < 8; ++s) zf[s] = *(const LAS bf16x8*)(z + r32 * (ZP * 2) + (16 * s + 8 * hh) * 2);
    const bf16* wg = WgT + (size_t)g * 16384;
    bf16* orow = PZ + (size_t)(row_base + r32) * 512 + g * 128;
#pragma unroll
    for (int db = 0; db < 4; ++db) {
        f32x16 acc = {};
#pragma unroll
        for (int s = 0; s < 8; ++s) { const bf16x8 wa = *(const bf16x8*)(wg + (size_t)(db * 32 + r32) * 128 + 16 * s + 8 * hh); acc = __builtin_amdgcn_mfma_f32_32x32x16_bf16(wa, zf[s], acc, 0, 0, 0); }
#pragma unroll
        for (int q4 = 0; q4 < 4; ++q4) { const int d0 = db * 32 + 8 * q4 + 4 * hh; const f32x4 sc = *(const f32x4*)(scale + g * 128 + d0);
            u32x2 o; o.x = pkbf(acc[4 * q4] * sc[0], acc[4 * q4 + 1] * sc[1]); o.y = pkbf(acc[4 * q4 + 2] * sc[2], acc[4 * q4 + 3] * sc[3]);
            *(u32x2*)(orow + d0) = o; }
    }
}
__device__ __forceinline__ void pool_item(int item, const bf16* U, const float* ctx, const bf16* WgT, const float* scale, bf16* PZ, int lane, LAS unsigned char* wl) {
    LAS unsigned* z = (LAS unsigned*)wl;
    int g, row_base;
    if (item < 2048) { const int b = item >> 8, tt = (item >> 2) & 63; g = item & 3; row_base = b * SEQ + tt * 32;
        if (g == 0) pool_fill_prompt<0>(U, b, tt, lane, z); else if (g == 1) pool_fill_prompt<1>(U, b, tt, lane, z); else if (g == 2) pool_fill_prompt<2>(U, b, tt, lane, z); else pool_fill_prompt<3>(U, b, tt, lane, z);
    } else { const int sg = (item - 2048) >> 2; g = item & 3; row_base = MP + sg * 32;
        if (g == 0) pool_fill_sample<0>(U, ctx, sg, lane, z); else if (g == 1) pool_fill_sample<1>(U, ctx, sg, lane, z); else if (g == 2) pool_fill_sample<2>(U, ctx, sg, lane, z); else pool_fill_sample<3>(U, ctx, sg, lane, z); }
    LDS_WAIT(); asm volatile("" ::: "memory");
    pool_mma(WgT, scale, PZ, g, row_base, lane, wl);
    LDS_WAIT(); asm volatile("" ::: "memory");
}

__device__ __forceinline__ int kvoff(int row, int col) { return row * 128 + ((((col >> 3) ^ (row & 7))) << 4) + ((col & 7) << 1); }
__device__ __forceinline__ void attn_prompt_item(int item, bf16* QO, const bf16* Kb, const bf16* Vb, const float* sinks, LAS unsigned char* lds, int tid, int wave, int lane) {
    const int n = item & 15, kvh = (item >> 4) & 1, b = item >> 5;
    const size_t tok0 = (size_t)b * SEQ; const int P0 = n * 128;
    const int lr0 = (n == 0) ? 128 : 0;
    for (int idx = tid; idx < 256 * 8; idx += NTHR) { const int lr = idx >> 3, ch = idx & 7;
        if (lr >= lr0) { const size_t src = (tok0 + P0 - 128 + lr) * 128 + kvh * 64 + ch * 8; const int dst = lr * 128 + ((ch ^ (lr & 7)) << 4);
            *(LAS u32x4*)(lds + dst) = *(const u32x4*)(Kb + src); *(LAS u32x4*)(lds + 32768 + dst) = *(const u32x4*)(Vb + src); } }
    __syncthreads();
    const int g = wave & 3, qh = wave >> 2, h = kvh * 4 + g, r32 = lane & 31, hh = lane >> 5;
    const float SC = 0.125f * 1.4426950408889634f; const float sinkv = sinks[h] * 1.4426950408889634f;
#pragma unroll 1
    for (int sbi = 0; sbi < 2; ++sbi) { const int sb = qh * 2 + sbi, i0 = 32 * sb;
        bf16* qrow = QO + (tok0 + P0 + i0 + r32) * 512 + h * 64;
        bf16x8 qr[4];
#pragma unroll
        for (int s = 0; s < 4; ++s) qr[s] = *(const bf16x8*)(qrow + 16 * s + 8 * hh);
        const int c0 = (n == 0) ? (4 - sb) : 0;
        f32x16 p[5]; float mx = sinkv;
#pragma unroll
        for (int c = 0; c < 5; ++c) { p[c] = (f32x16){};
            if (c >= c0) { const int kk0 = i0 + 32 * c; f32x16 a = {};
#pragma unroll
                for (int s = 0; s < 4; ++s) { const bf16x8 kf = *(const LAS bf16x8*)(lds + kvoff(kk0 + r32, 16 * s + 8 * hh)); a = __builtin_amdgcn_mfma_f32_32x32x16_bf16(kf, qr[s], a, 0, 0, 0); }
#pragma unroll
                for (int r = 0; r < 16; ++r) { const int kj = crow(r, hh); float v = a[r] * SC;
                    if (c == 0 && kj < r32) v = -INFINITY; if (c == 4 && kj > r32) v = -INFINITY;
                    a[r] = v; mx = fmaxf(mx, v); }
                p[c] = a; } }
        mx = fmaxf(mx, __shfl_xor(mx, 32));
        float l = 0.f;
#pragma unroll
        for (int c = 0; c < 5; ++c) if (c >= c0) {
#pragma unroll
            for (int r = 0; r < 16; ++r) { const float e = __builtin_amdgcn_exp2f(p[c][r] - mx); p[c][r] = e; l += e; } }
        l += __shfl_xor(l, 32); l += __builtin_amdgcn_exp2f(sinkv - mx);
        const float linv = 1.0f / l;
        f32x16 o[2]; o[0] = (f32x16){}; o[1] = (f32x16){};
        const int vrow = 4 * hh + ((lane & 15) >> 2), vcol = 16 * ((lane >> 4) & 1) + 4 * (lane & 3);
#pragma unroll
        for (int c = 0; c < 5; ++c) if (c >= c0) { const int kk0 = i0 + 32 * c;
#pragma unroll
            for (int s = 0; s < 2; ++s) {
                u32x4 pw; pw.x = pkbf(p[c][8 * s], p[c][8 * s + 1]); pw.y = pkbf(p[c][8 * s + 2], p[c][8 * s + 3]); pw.z = pkbf(p[c][8 * s + 4], p[c][8 * s + 5]); pw.w = pkbf(p[c][8 * s + 6], p[c][8 * s + 7]);
                const bf16x8 pa = __builtin_bit_cast(bf16x8, pw);
#pragma unroll
                for (int db = 0; db < 2; ++db) {
                    const s16x4 lo = __builtin_bit_cast(s16x4, __builtin_amdgcn_ds_read_tr16_b64_v4i16((LAS s16x4*)(lds + 32768 + kvoff(kk0 + 16 * s + vrow, db * 32 + vcol))));
                    const s16x4 hi = __builtin_bit_cast(s16x4, __builtin_amdgcn_ds_read_tr16_b64_v4i16((LAS s16x4*)(lds + 32768 + kvoff(kk0 + 16 * s + 8 + vrow, db * 32 + vcol))));
                    const bf16x8 vb = __builtin_shufflevector(lo, hi, 0, 1, 2, 3, 4, 5, 6, 7);
                    o[db] = __builtin_amdgcn_mfma_f32_32x32x16_bf16(pa, vb, o[db], 0, 0, 0); } } }
        bf16* orow0 = QO + (tok0 + P0 + i0) * 512 + h * 64 + r32;
#pragma unroll
        for (int r = 0; r < 16; ++r) { const int qi = crow(r, hh); const float li = __shfl(linv, qi);
            orow0[(size_t)qi * 512] = (bf16)(pkbf(o[0][r] * li, 0.f) & 0xffffu); orow0[(size_t)qi * 512 + 32] = (bf16)(pkbf(o[1][r] * li, 0.f) & 0xffffu); }
    }
    __syncthreads();
}
__device__ __forceinline__ void attn_sample_item(int item, bf16* QO, const bf16* Kb, const bf16* Vb, const float* kc, const float* vc, const float* sinks, LAS unsigned char* wl, int lane) {
    const int s = item >> 1, kvh = item & 1;
    LAS float* qs = (LAS float*)wl;
    LAS float* ps = (LAS float*)(wl + 4096);
    { const int rr = lane >> 2, t = rr >> 2, g = rr & 3, d0 = (lane & 3) * 16;
      const bf16* qp = QO + (size_t)(MP + 4 * s + t) * 512 + (kvh * 4 + g) * 64 + d0;
      const u32x4 a = *(const u32x4*)qp, b2 = *(const u32x4*)(qp + 8);
      LAS float* d = qs + rr * 64 + d0;
      d[0] = bflo(a.x); d[1] = bfhi(a.x); d[2] = bflo(a.y); d[3] = bfhi(a.y); d[4] = bflo(a.z); d[5] = bfhi(a.z); d[6] = bflo(a.w); d[7] = bfhi(a.w);
      d[8] = bflo(b2.x); d[9] = bfhi(b2.x); d[10] = bflo(b2.y); d[11] = bfhi(b2.y); d[12] = bflo(b2.z); d[13] = bfhi(b2.z); d[14] = bflo(b2.w); d[15] = bfhi(b2.w); }
    LDS_WAIT(); asm volatile("" ::: "memory");
    const float SC = 0.125f * 1.4426950408889634f;
#pragma unroll 1
    for (int ci = 0; ci < 3; ++ci) { const int key = ci * 64 + lane;
        float kv[64];
        if (key < 128) { const f32x4* kp = (const f32x4*)(kc + (((size_t)s * 128 + key) * 2 + kvh) * 64);
#pragma unroll
            for (int j = 0; j < 16; ++j) { const f32x4 v = kp[j]; kv[4 * j] = v[0]; kv[4 * j + 1] = v[1]; kv[4 * j + 2] = v[2]; kv[4 * j + 3] = v[3]; }
        } else { const int kn = key < 132 ? key - 128 : 0; const u32x4* kp = (const u32x4*)(Kb + (size_t)(MP + 4 * s + kn) * 128 + kvh * 64);
#pragma unroll
            for (int j = 0; j < 8; ++j) { const u32x4 v = kp[j]; kv[8 * j] = bflo(v.x); kv[8 * j + 1] = bfhi(v.x); kv[8 * j + 2] = bflo(v.y); kv[8 * j + 3] = bfhi(v.y); kv[8 * j + 4] = bflo(v.z); kv[8 * j + 5] = bfhi(v.z); kv[8 * j + 6] = bflo(v.w); kv[8 * j + 7] = bfhi(v.w); } }
#pragma unroll 1
        for (int rr = 0; rr < 16; ++rr) { float dot = 0.f; asm volatile("" ::: "memory");
#pragma unroll
            for (int j = 0; j < 16; ++j) { const f32x4 q = *(const LAS f32x4*)(qs + rr * 64 + 4 * j); dot += q[0] * kv[4 * j] + q[1] * kv[4 * j + 1] + q[2] * kv[4 * j + 2] + q[3] * kv[4 * j + 3]; }
            const int t = rr >> 2; const bool valid = key < 128 ? key >= t : (key < 132 && key - 128 <= t);
            if (key < 136) ps[rr * 136 + key] = valid ? dot * SC : -INFINITY; } }
    LDS_WAIT(); asm volatile("" ::: "memory");
#pragma unroll 1
    for (int rr = 0; rr < 16; ++rr) { const float sinkv = sinks[kvh * 4 + (rr & 3)] * 1.4426950408889634f;
        const float x0 = ps[rr * 136 + lane], x1 = ps[rr * 136 + 64 + lane], x2 = lane < 8 ? ps[rr * 136 + 128 + lane] : -INFINITY;
        const float m = fmaxf(wave_max(fmaxf(fmaxf(x0, x1), x2)), sinkv);
        const float e0 = __builtin_amdgcn_exp2f(x0 - m), e1 = __builtin_amdgcn_exp2f(x1 - m), e2 = __builtin_amdgcn_exp2f(x2 - m);
        const float l = wave_sum(e0 + e1 + e2) + __builtin_amdgcn_exp2f(sinkv - m); const float li = 1.0f / l;
        ps[rr * 136 + lane] = e0 * li; ps[rr * 136 + 64 + lane] = e1 * li; if (lane < 8) ps[rr * 136 + 128 + lane] = e2 * li; }
    LDS_WAIT(); asm volatile("" ::: "memory");
    float o[16];
#pragma unroll
    for (int rr = 0; rr < 16; ++rr) o[rr] = 0.f;
#pragma unroll 1
    for (int k4 = 0; k4 < 33; ++k4) { float v[4];
#pragma unroll
        for (int j = 0; j < 4; ++j) { const int key = 4 * k4 + j;
            v[j] = key < 128 ? vc[(((size_t)s * 128 + key) * 2 + kvh) * 64 + lane] : __uint_as_float((unsigned)Vb[(size_t)(MP + 4 * s + key - 128) * 128 + kvh * 64 + lane] << 16); }
#pragma unroll
        for (int rr = 0; rr < 16; ++rr) { const f32x4 pp = *(const LAS f32x4*)(ps + rr * 136 + 4 * k4); o[rr] += pp[0] * v[0] + pp[1] * v[1] + pp[2] * v[2] + pp[3] * v[3]; } }
#pragma unroll
    for (int rr = 0; rr < 16; ++rr) QO[(size_t)(MP + 4 * s + (rr >> 2)) * 512 + (kvh * 4 + (rr & 3)) * 64 + lane] = (bf16)(pkbf(o[rr], 0.f) & 0xffffu);
    LDS_WAIT(); asm volatile("" ::: "memory");
}
#ifndef MK_PER_PHASE
#define MK_PER_PHASE 1
#endif
__global__ void __launch_bounds__(NTHR, 2) mega_fwd(Args a) {
    extern __shared__ __attribute__((aligned(16))) unsigned char lds_raw[];
    LAS unsigned char* lds = (LAS unsigned char*)lds_raw;
    const int tid = threadIdx.x, lane = tid & 63, wave = __builtin_amdgcn_readfirstlane(tid >> 6);
    const int G = gridDim.x, bx = blockIdx.x, vcu = (G % 8 == 0) ? (bx % 8) * (G / 8) + bx / 8 : bx;
    const int gw = vcu * NWAVES + wave, NGW = G * NWAVES;
    unsigned char* ws = a.ws;
    bf16* XN = (bf16*)(ws + WS_XN); float* R = (float*)(ws + WS_R); bf16* HID = (bf16*)(ws + WS_BIG);
    bf16* Gt = (bf16*)(ws + WS_G); bf16* Ub = (bf16*)(ws + WS_U); bf16* Kb = (bf16*)(ws + WS_K); bf16* Vb = (bf16*)(ws + WS_V); bf16* QO = (bf16*)(ws + WS_Q);
    bf16* PZ = XN; bf16* MPRE = (bf16*)a.out;
    const int lo = a.ph_lo, hi = a.ph_hi;
#ifndef PH_MASK
#define PH_MASK 0xFFF
#endif
#define IN(k) ((((PH_MASK) >> (k)) & 1) && lo <= (k) && (k) < hi)
#if MK_PER_PHASE
#define SEAM(k) do { } while (0)
#else
#define SEAM(k) do { if (IN(k) && IN((k) + 1)) { cg::this_grid().sync(); } } while (0)
#endif

    if (IN(0)) { p0_prologue(a, lds, vcu, G, wave, lane, tid); }
    SEAM(0);
    if (IN(1)) {
        pg8::Gemm g{XN, (const bf16*)(ws + WS_W13A), M, NUP, D}; pg8::StaticOrder S; S.init(M, NUP, G, bx);
        pg8::EpiSwiGLU E{HID, DFF};
        pg8::gemm_phase<pg8::EpiSwiGLU, pg8::StaticOrder, true, true>(lds, g, S, E);
    }
    SEAM(1);
    if (IN(2)) {
        pg8::Gemm g{HID, (const bf16*)(ws + WS_W2A), M, D, DFF}; pg8::StaticOrder S; S.init(M, D, G, bx);
        pg8::EpiResid E{a.in[0], a.in[1], R, ALPHA, 0.5f};
        pg8::gemm_phase<pg8::EpiResid, pg8::StaticOrder, true, true>(lds, g, S, E);
    }
    SEAM(2);
    if (IN(3)) { ln_rows(R, a.in[18], a.in[19], R, XN, gw, NGW, lane); }
    SEAM(3);
    if (IN(4)) {
        pg8::Gemm g{XN, (const bf16*)(ws + WS_WIN), M, NIN, D}; pg8::StaticOrder S; S.init(M, NIN, G, bx);
        pg8::EpiInProj E{Ub, QO, Kb, Vb, Gt, (const float*)(ws + WS_ROPEC), (const float*)(ws + WS_ROPES), a.out};
        pg8::gemm_phase<pg8::EpiInProj, pg8::StaticOrder, true, true>(lds, g, S, E);
    }
    SEAM(4);
    if (IN(5)) {
        for (int it = vcu; it < 256; it += G) attn_prompt_item(it, QO, Kb, Vb, a.in[8], lds, tid, wave, lane);
        LAS unsigned char* wl = lds + wave * 16384;
        for (int it = gw; it < 2048; it += NGW) pool_item(it, Ub, a.in[2], (const bf16*)(ws + WS_WG), a.in[7], PZ, lane, wl);
        if (wave == 1) for (int it = vcu; it < 64; it += G) pool_item(2048 + it, Ub, a.in[2], (const bf16*)(ws + WS_WG), a.in[7], PZ, lane, wl);
        if (wave == 0) for (int it = vcu; it < 256; it += G) attn_sample_item(it, QO, Kb, Vb, a.in[3], a.in[4], a.in[8], wl, lane);
    }
    SEAM(5);
    if (IN(6)) {
        pg8::StaticOrder S; S.init(M, D, G, bx);
        { pg8::Gemm g{PZ, (const bf16*)(ws + WS_WP), M, D, 512}; pg8::EpiMerge<true> E{Gt, MPRE}; pg8::gemm_phase<pg8::EpiMerge<true>, pg8::StaticOrder, true, true>(lds, g, S, E); }
        { pg8::Gemm g{QO, (const bf16*)(ws + WS_WA), M, D, 512}; pg8::EpiMerge<false> E{Gt, MPRE}; pg8::gemm_phase<pg8::EpiMerge<false>, pg8::StaticOrder, true, true>(lds, g, S, E); }
    }
    SEAM(6);
    if (IN(7)) {
        pg8::Gemm g{MPRE, (const bf16*)(ws + WS_WOUT), M, D, D}; pg8::StaticOrder S; S.init(M, D, G, bx);
        pg8::EpiResid E{R, R + (size_t)MP * D, R, ALPHA, 1.0f};
        pg8::gemm_phase<pg8::EpiResid, pg8::StaticOrder, true, true>(lds, g, S, E);
    }
    SEAM(7);
    if (IN(8)) { ln_rows(R, a.in[20], a.in[21], R, XN, gw, NGW, lane); }
    SEAM(8);
    if (IN(9)) {
        pg8::Gemm g{XN, (const bf16*)(ws + WS_W13B), M, NUP, D}; pg8::StaticOrder S; S.init(M, NUP, G, bx);
        pg8::EpiSwiGLU E{HID, DFF};
        pg8::gemm_phase<pg8::EpiSwiGLU, pg8::StaticOrder, true, true>(lds, g, S, E);
    }
    SEAM(9);
    if (IN(10)) {
        pg8::Gemm g{HID, (const bf16*)(ws + WS_W2B), M, D, DFF}; pg8::StaticOrder S; S.init(M, D, G, bx);
        pg8::EpiResid E{R, R + (size_t)MP * D, R, ALPHA, 0.5f};
        pg8::gemm_phase<pg8::EpiResid, pg8::StaticOrder, true, true>(lds, g, S, E);
    }
    SEAM(10);
    if (IN(11)) { ln_rows(R, a.in[22], a.in[23], a.out, nullptr, gw, NGW, lane); }
#undef IN
#undef SEAM
}

extern "C" void kernel_launch(void* const* d_in, const int* in_sizes, int n_in, void* d_out, int out_size, void* d_ws, size_t ws_size, hipStream_t stream) {
    static int grid = 0;
    if (grid == 0) {
        if (n_in != 24 || in_sizes[0] != MP * D || (size_t)out_size != OUT_TOTAL || ws_size < WS_END) {
            fprintf(stderr, "kernel_launch: unexpected shapes (n_in %d, in0 %d, out %d, ws %zu; need ws >= %zu, out %zu); nothing launched\n", n_in, n_in > 0 ? in_sizes[0] : -1, out_size, ws_size, (size_t)WS_END, (size_t)OUT_TOTAL); grid = -1; return; }
        int dev = 0, cus = 0, per_cu = 0;
        if (hipGetDevice(&dev) != hipSuccess || hipDeviceGetAttribute(&cus, hipDeviceAttributeMultiprocessorCount, dev) != hipSuccess) { fprintf(stderr, "kernel_launch: device query failed\n"); grid = -1; return; }
        if (hipFuncSetAttribute((const void*)mega_fwd, hipFuncAttributeMaxDynamicSharedMemorySize, LDS_BYTES) != hipSuccess) { fprintf(stderr, "kernel_launch: hipFuncSetAttribute failed\n"); grid = -1; return; }
        if (hipOccupancyMaxActiveBlocksPerMultiprocessor(&per_cu, (const void*)mega_fwd, NTHR, LDS_BYTES) != hipSuccess || per_cu < 1) { fprintf(stderr, "kernel_launch: occupancy query says %d blocks per CU\n", per_cu); (void)hipGetLastError(); grid = -1; return; }
        grid = cus * 1;
    }
    if (grid < 0) return;
    Args a{};
    for (int i = 0; i < 24; ++i) a.in[i] = (const float*)d_in[i];
    a.out = (float*)d_out; a.ws = (unsigned char*)d_ws;
#if MK_PER_PHASE
    for (int p = 0; p < NPHASE; ++p) { a.ph_lo = p; a.ph_hi = p + 1; hipLaunchKernelGGL(mega_fwd, dim3(grid), dim3(NTHR), LDS_BYTES, stream, a); }
#else
    a.ph_lo = 0; a.ph_hi = NPHASE;
    void* args[] = {&a};
    hipError_t e = hipLaunchCooperativeKernel((const void*)mega_fwd, dim3(grid), dim3(NTHR), args, LDS_BYTES, stream);
    if (e != hipSuccess) fprintf(stderr, "kernel_launch: cooperative launch failed: %s (grid %d)\n", hipGetErrorString(e), grid);
#endif
}
```
